# Optimizing an MI355X kernel written in HIP

```python
import jax, jax.numpy as jnp
from jax import lax
import numpy as np

D_MODEL = 4096
BATCH = 1
SEQ = 8192
DEPTH = 1

MIX_WIDTH = D_MODEL
CONV_WIDTH = MIX_WIDTH // 2
ATTN_WIDTH = MIX_WIDTH - CONV_WIDTH
HEAD_DIM = 128
N_Q_HEADS = ATTN_WIDTH // HEAD_DIM
N_KV_HEADS = max(1, N_Q_HEADS // 4)
GQA_GROUP = N_Q_HEADS // N_KV_HEADS
KV_WIDTH = N_KV_HEADS * HEAD_DIM
WINDOW = 128
BLOCK = 128
DN_ALPHA = (2.0 * DEPTH) ** 0.25
DN_BETA = (8.0 * DEPTH) ** -0.25
LN_EPS = 1e-5
NEG_INF = -1e30

OFF_CB = 0
OFF_CC = OFF_CB + CONV_WIDTH
OFF_CH = OFF_CC + CONV_WIDTH
OFF_CZ = OFF_CH + CONV_WIDTH
OFF_Q = OFF_CZ + CONV_WIDTH
OFF_K = OFF_Q + ATTN_WIDTH
OFF_V = OFF_K + KV_WIDTH
OFF_AZ = OFF_V + KV_WIDTH
PROJ_WIDTH = OFF_AZ + ATTN_WIDTH

kernel_name = "hybrid_shortconv_swa_deepnorm_encoder"


def layer_norm(x, g, b):
    xf = x.astype(jnp.float32)
    mu = jnp.mean(xf, axis=-1, keepdims=True)
    var = jnp.mean(jnp.square(xf - mu), axis=-1, keepdims=True)
    y = (xf - mu) * lax.rsqrt(var + LN_EPS) * g.astype(jnp.float32) + b.astype(jnp.float32)
    return y.astype(x.dtype)


def alibi_slopes(n_heads):
    h = jnp.arange(1, n_heads + 1, dtype=jnp.float32)
    return jnp.exp2(-8.0 * h / n_heads)


def centred_short_conv(u, w):
    up = jnp.pad(u, ((0, 0), (1, 1), (0, 0)))
    return up[:, :-2] * w[0] + up[:, 1:-1] * w[1] + up[:, 2:] * w[2]


def banded_window_attention(q, k, v, sink):
    b, s, _ = q.shape
    nb = s // BLOCK
    qb = q.reshape(b, nb, BLOCK, N_KV_HEADS, GQA_GROUP, HEAD_DIM).astype(jnp.float32)

    def band(t):
        t = t.reshape(b, nb, BLOCK, N_KV_HEADS, HEAD_DIM).astype(jnp.float32)
        tp = jnp.pad(t, ((0, 0), (1, 1), (0, 0), (0, 0), (0, 0)))
        return jnp.concatenate([tp[:, :-2], tp[:, 1:-1], tp[:, 2:]], axis=2)

    kb, vb = band(k), band(v)
    scores = jnp.einsum("bnqhgd,bnkhd->bnhgqk", qb, kb) * (HEAD_DIM ** -0.5)

    blk = jnp.arange(nb, dtype=jnp.int32)[:, None]
    q_pos = blk * BLOCK + jnp.arange(BLOCK, dtype=jnp.int32)[None, :]
    k_pos = (blk - 1) * BLOCK + jnp.arange(3 * BLOCK, dtype=jnp.int32)[None, :]
    dist = jnp.abs(q_pos[:, :, None] - k_pos[:, None, :])
    valid = (dist <= WINDOW) & (k_pos[:, None, :] >= 0) & (k_pos[:, None, :] < s)

    slopes = alibi_slopes(N_Q_HEADS).reshape(N_KV_HEADS, GQA_GROUP)
    bias = -slopes[None, None, :, :, None, None] * dist[None, :, None, None].astype(jnp.float32)
    scores = jnp.where(valid[None, :, None, None], scores + bias, NEG_INF)

    sink_l = sink.astype(jnp.float32).reshape(1, 1, N_KV_HEADS, GQA_GROUP, 1, 1)
    m = jnp.maximum(jnp.max(scores, axis=-1, keepdims=True), sink_l)
    p = jnp.exp(scores - m)
    denom = jnp.sum(p, axis=-1, keepdims=True) + jnp.exp(sink_l - m)
    out = jnp.einsum("bnhgqk,bnkhd->bnqhgd", p / denom, vb)
    return out.reshape(b, s, ATTN_WIDTH).astype(q.dtype)


def hybrid_layer(x, w_in, conv_w, sink, w_out, ln_g, ln_b):
    p = x @ w_in
    c_b = p[..., OFF_CB:OFF_CC]
    c_c = p[..., OFF_CC:OFF_CH]
    c_h = p[..., OFF_CH:OFF_CZ]
    c_z = p[..., OFF_CZ:OFF_Q]
    a_q = p[..., OFF_Q:OFF_K]
    a_k = p[..., OFF_K:OFF_V]
    a_v = p[..., OFF_V:OFF_AZ]
    a_z = p[..., OFF_AZ:PROJ_WIDTH]

    y_conv = c_b * centred_short_conv(c_c * c_h, conv_w) * jax.nn.silu(c_z)
    y_attn = banded_window_attention(a_q, a_k, a_v, sink) * jax.nn.silu(a_z)

    y = jnp.concatenate([y_conv, y_attn], axis=-1) @ w_out
    return layer_norm(DN_ALPHA * x + y, ln_g, ln_b)


def setup_inputs(seed: int = 0) -> dict:
    key = jax.random.key(seed)
    ks = jax.random.split(key, 10)
    x = jax.random.normal(ks[0], (BATCH, SEQ, D_MODEL), jnp.float32)
    emb_ln_g = 1.0 + 0.02 * jax.random.normal(ks[1], (D_MODEL,), jnp.float32)
    emb_ln_b = 0.02 * jax.random.normal(ks[2], (D_MODEL,), jnp.float32)
    col_scale = (jnp.ones((PROJ_WIDTH,), jnp.float32)
                 .at[OFF_CH:OFF_CZ].set(DN_BETA)
                 .at[OFF_V:OFF_AZ].set(DN_BETA))
    w_in = (jax.random.normal(ks[3], (DEPTH, D_MODEL, PROJ_WIDTH), jnp.float32)
            * (D_MODEL ** -0.5) * col_scale)
    conv_w = jax.random.normal(ks[4], (DEPTH, 3, CONV_WIDTH), jnp.float32) * (3.0 ** -0.5)
    sink = 0.5 * jax.random.normal(ks[5], (DEPTH, N_Q_HEADS), jnp.float32)
    w_out = (jax.random.normal(ks[6], (DEPTH, MIX_WIDTH, D_MODEL), jnp.float32)
             * (MIX_WIDTH ** -0.5) * DN_BETA)
    ln_g = 1.0 + 0.02 * jax.random.normal(ks[7], (DEPTH, D_MODEL), jnp.float32)
    ln_b = 0.02 * jax.random.normal(ks[8], (DEPTH, D_MODEL), jnp.float32)
    return {"x": x, "emb_ln_g": emb_ln_g, "emb_ln_b": emb_ln_b, "w_in": w_in,
            "conv_w": conv_w, "sink": sink, "w_out": w_out, "ln_g": ln_g, "ln_b": ln_b}


def reference(x, emb_ln_g, emb_ln_b, w_in, conv_w, sink, w_out, ln_g, ln_b):
    h = layer_norm(x, emb_ln_g, emb_ln_b)
    for l in range(DEPTH):
        h = hybrid_layer(h, w_in[l], conv_w[l], sink[l], w_out[l], ln_g[l], ln_b[l])
    return h
```

```cpp
#include <hip/hip_runtime.h>
#include <hip/hip_cooperative_groups.h>
#include <cstdio>
namespace cg = cooperative_groups;

#ifndef N_LAUNCHES
#define N_LAUNCHES 5
#endif

#define LAS __attribute__((address_space(3)))
typedef unsigned short bf16_t;
typedef short bf16x8 __attribute__((ext_vector_type(8)));
typedef short s16x4 __attribute__((ext_vector_type(4)));
typedef float f32x4 __attribute__((ext_vector_type(4)));
typedef float f32x2 __attribute__((ext_vector_type(2)));
typedef float f32x16 __attribute__((ext_vector_type(16)));
typedef unsigned u32x4 __attribute__((ext_vector_type(4)));
typedef unsigned u32x2 __attribute__((ext_vector_type(2)));

constexpr int SEQ = 8192, DM = 4096, PW = 13312, CW = 2048, QW = 5120;
constexpr int QOFF_K = 2048, QOFF_V = 2560, QOFF_Z = 3072;
constexpr float LN_EPS = 1e-5f;
constexpr float DN_ALPHA = 1.189207115002721f;
constexpr float LOG2E = 1.4426950408889634f;
constexpr int LDS_BYTES = 131072 + 4096;

constexpr size_t WS_WIN = 0;
constexpr size_t WS_WOUT = WS_WIN + (size_t)PW * DM * 2;
constexpr size_t WS_XN = WS_WOUT + (size_t)DM * DM * 2;
constexpr size_t WS_UG = WS_XN + (size_t)SEQ * DM * 2;
constexpr size_t WS_QKVZ = WS_UG + (size_t)SEQ * CW * 4;
constexpr size_t WS_Y = WS_QKVZ + (size_t)SEQ * QW * 2;
constexpr size_t WS_STATS = WS_Y + (size_t)SEQ * DM * 2;
constexpr size_t WS_END = WS_STATS + (size_t)SEQ * 8;

struct Params {
    const float* x; const float* g1; const float* b1; const float* w_in; const float* conv_w; const float* sink; const float* w_out; const float* g2; const float* b2;
    float* out; unsigned char* ws;
    int ph_lo, ph_hi;
};

__device__ __forceinline__ unsigned pk2(float lo, float hi) { unsigned r; asm volatile("v_cvt_pk_bf16_f32 %0, %1, %2" : "=v"(r) : "v"(lo), "v"(hi)); return r; }
__device__ __forceinline__ float bf_lo(unsigned w) { return __uint_as_float(w << 16); }
__device__ __forceinline__ float bf_hi(unsigned w) { return __uint_as_float(w & 0xffff0000u); }
__device__ __forceinline__ float silu_f(float z) { return z * __builtin_amdgcn_rcpf(1.0f + __builtin_amdgcn_exp2f(-LOG2E * z)); }
__device__ __forceinline__ float wave_sum(float v) {
#pragma unroll
    for (int o = 1; o < 64; o <<= 1) v += __shfl_xor(v, o);
    return v;
}

namespace pg8 {
constexpr int BM = 256, BK = 64, HALF = 128, HTB = HALF * BK * 2, STAGE_BYTES = 8 * HTB, NXCD = 8, WGM = 8;
__host__ __device__ __forceinline__ int lds_byte(int r, int c) { const int st = (r >> 4) * 2 + (c >> 5), rr = r & 15, cc = c & 31, ob = rr * 64 + cc * 2; return st * 1024 + (ob ^ (((ob >> 9) & 1) << 5)); }
__host__ __device__ __forceinline__ void stage_rc(int b, int& R, int& C) { const int st = b / 1024, sb = b % 1024, swz = sb ^ (((sb >> 9) & 1) << 5); R = (st >> 1) * 16 + swz / 64; C = (st & 1) * 32 + (swz % 64) / 2; }
struct Unit { int pm, pn; };
struct Gemm { const bf16_t* A; const bf16_t* Bt; int M, N, K; };
struct StaticOrder {
    int nM, nN, nwg, G, c;
    __device__ void init(int M, int N, int G_, int c_) { nM = M / BM; nN = N / BM; nwg = nM * nN; G = G_; c = c_; }
    __device__ bool next(int i, Unit& u) const {
        const long L = (long)i * G + c; if (L >= nwg) return false;
        int wgid = (int)L; { const int q = nwg / NXCD, r = nwg % NXCD, xcd = wgid % NXCD, off = wgid / NXCD; wgid = (xcd < r ? xcd * (q + 1) : r * (q + 1) + (xcd - r) * q) + off; }
        const int nig = WGM * nN, gid = wgid / nig, fm = gid * WGM, gsz = (nM - fm) < WGM ? (nM - fm) : WGM;
        u.pm = fm + ((wgid % nig) % gsz); u.pn = (wgid % nig) / gsz; return true;
    }
};

template <class Epi>
__device__ __forceinline__ void gemm_phase(LAS unsigned char* lds, const Gemm g, const StaticOrder& S, const Epi& E) {
    const int tid = threadIdx.x, wid = __builtin_amdgcn_readfirstlane(tid >> 6), lane = tid & 63, wr = wid >> 2, wc = wid & 3, fr = lane & 15, fq = lane >> 4;
    const int K = g.K, nt = K / BK;
    unsigned voffA[2];
#pragma unroll
    for (int i = 0; i < 2; ++i) { int R, C; stage_rc(tid * 16 + i * 8192, R, C); voffA[i] = (unsigned)(R * K + C) * 2u; }
    const size_t kstep = (size_t)(BK * 2);
    const size_t hstep = (size_t)HALF * K * 2;
    const size_t tstep = 2 * hstep;
    const unsigned ldsw = (unsigned)wid * 1024u;
    const int aoff = lds_byte(wr * 64 + fr, fq * 8), boff = lds_byte(wc * 32 + fr, fq * 8);
#define PG8_SA(b, h) (((b) * 2 + (h)) * HTB)
#define PG8_SB(b, h) ((4 + (b) * 2 + (h)) * HTB)
#define PG8_STAGE(bufoff, gbase) do { _Pragma("unroll") for (int _i = 0; _i < 2; ++_i) \
        __builtin_amdgcn_global_load_lds((const unsigned*)((const char*)(gbase) + voffA[_i]), (LAS unsigned*)(lds + (bufoff) + ldsw + _i * 8192), 16, 0, 0); } while (0)
#define PG8_LDA(dst, b, h) do { _Pragma("unroll") for (int m = 0; m < 4; ++m) _Pragma("unroll") for (int k = 0; k < 2; ++k) dst[m][k] = *(const LAS bf16x8*)(lds + PG8_SA(b, h) + aoff + m * 2048 + k * 1024); } while (0)
#define PG8_LDB(dst, b, h) do { _Pragma("unroll") for (int n = 0; n < 2; ++n) _Pragma("unroll") for (int k = 0; k < 2; ++k) dst[n][k] = *(const LAS bf16x8*)(lds + PG8_SB(b, h) + boff + n * 2048 + k * 1024); } while (0)
#define PG8_MMA(ai, bj, At, Bt) do { __builtin_amdgcn_s_setprio(1); _Pragma("unroll") for (int m = 0; m < 4; ++m) _Pragma("unroll") for (int n = 0; n < 2; ++n) _Pragma("unroll") for (int k = 0; k < 2; ++k) \
        acc[ai][bj][m][n] = __builtin_amdgcn_mfma_f32_16x16x32_bf16(Bt[n][k], At[m][k], acc[ai][bj][m][n], 0, 0, 0); __builtin_amdgcn_s_setprio(0); } while (0)
#define PG8_WAIT_V(n) asm volatile("s_waitcnt vmcnt(" #n ")" ::: "memory")
#define PG8_WAIT_L(n) asm volatile("s_waitcnt lgkmcnt(" #n ")" ::: "memory")
#define PG8_BAR __builtin_amdgcn_s_barrier()
#define PG8_SCHED __builtin_amdgcn_sched_barrier(0)
    Unit cur, nxt; int ui = 0;
    if (!S.next(0, cur)) return;
    f32x4 acc[2][2][4][2];
#pragma unroll
    for (int a = 0; a < 2; ++a)
#pragma unroll
        for (int b = 0; b < 2; ++b)
#pragma unroll
            for (int m = 0; m < 4; ++m)
#pragma unroll
                for (int n = 0; n < 2; ++n) acc[a][b][m][n] = (f32x4){0.f, 0.f, 0.f, 0.f};
    bf16x8 At[4][2], B0[2][2], B1[2][2];
    const char* cA = (const char*)g.A + (size_t)cur.pm * tstep; const char* cB = (const char*)g.Bt + (size_t)cur.pn * tstep;
    PG8_STAGE(PG8_SB(0, 0), cB); PG8_STAGE(PG8_SA(0, 0), cA); PG8_STAGE(PG8_SB(0, 1), cB + hstep); PG8_STAGE(PG8_SA(0, 1), cA + hstep);
    if (wr == 1) PG8_BAR;
    PG8_WAIT_V(4); PG8_BAR;
    PG8_STAGE(PG8_SB(1, 0), cB + kstep); PG8_STAGE(PG8_SA(1, 0), cA + kstep); PG8_STAGE(PG8_SB(1, 1), cB + hstep + kstep);
    PG8_WAIT_V(6); PG8_BAR;
    for (;;) {
        const bool has_next = S.next(ui + 1, nxt);
        const char* nA = has_next ? (const char*)g.A + (size_t)nxt.pm * tstep : cA; const char* nB = has_next ? (const char*)g.Bt + (size_t)nxt.pn * tstep : cB;
        for (int t = 0; t < nt; t += 2) {
            const bool last = (t == nt - 2);
            const char* a1 = cA + (size_t)(t + 1) * kstep;
            const char* a2 = last ? nA : cA + (size_t)(t + 2) * kstep; const char* b2 = last ? nB : cB + (size_t)(t + 2) * kstep;
            const char* a3 = a2 + kstep; const char* b3 = b2 + kstep;
            PG8_LDB(B0, 0, 0); PG8_SCHED; PG8_LDA(At, 0, 0); PG8_STAGE(PG8_SA(1, 1), a1 + hstep);
            PG8_WAIT_L(8); PG8_BAR; PG8_WAIT_L(0); PG8_MMA(0, 0, At, B0); PG8_BAR; PG8_SCHED;
            PG8_LDB(B1, 0, 1); PG8_STAGE(PG8_SB(0, 0), b2);
            PG8_BAR; PG8_WAIT_L(0); PG8_MMA(0, 1, At, B1); PG8_BAR;
            PG8_LDA(At, 0, 1); PG8_STAGE(PG8_SA(0, 0), a2);
            PG8_BAR; PG8_WAIT_L(0); PG8_MMA(1, 0, At, B0); PG8_BAR; PG8_SCHED;
            PG8_STAGE(PG8_SB(0, 1), b2 + hstep);
            PG8_WAIT_V(6); PG8_BAR; PG8_MMA(1, 1, At, B1); PG8_BAR;
            PG8_LDB(B0, 1, 0); PG8_SCHED; PG8_LDA(At, 1, 0); PG8_STAGE(PG8_SA(0, 1), a2 + hstep);
            PG8_WAIT_L(8); PG8_BAR; PG8_WAIT_L(0); PG8_MMA(0, 0, At, B0); PG8_BAR; PG8_SCHED;
            PG8_LDB(B1, 1, 1); PG8_STAGE(PG8_SB(1, 0), b3);
            PG8_BAR; PG8_WAIT_L(0); PG8_MMA(0, 1, At, B1); PG8_BAR;
            PG8_LDA(At, 1, 1); PG8_STAGE(PG8_SA(1, 0), a3);
            PG8_BAR; PG8_WAIT_L(0); PG8_MMA(1, 0, At, B0); PG8_BAR; PG8_SCHED;
            PG8_STAGE(PG8_SB(1, 1), b3 + hstep);
            PG8_WAIT_V(6); PG8_BAR; PG8_MMA(1, 1, At, B1); PG8_BAR;
        }
        E(acc, cur, wr, wc, fr, fq);
        if (!has_next) break;
#pragma unroll
        for (int a = 0; a < 2; ++a)
#pragma unroll
            for (int b = 0; b < 2; ++b)
#pragma unroll
                for (int m = 0; m < 4; ++m)
#pragma unroll
                    for (int n = 0; n < 2; ++n) acc[a][b][m][n] = (f32x4){0.f, 0.f, 0.f, 0.f};
        cur = nxt; cA = nA; cB = nB; ++ui;
    }
    PG8_WAIT_V(0);
    if (wr == 0) PG8_BAR;
    PG8_BAR;
#undef PG8_SA
#undef PG8_SB
#undef PG8_STAGE
#undef PG8_LDA
#undef PG8_LDB
#undef PG8_MMA
#undef PG8_WAIT_V
#undef PG8_WAIT_L
#undef PG8_BAR
#undef PG8_SCHED
}
}

struct Epi1 {
    bf16_t* UG; bf16_t* QKVZ;
    __device__ __forceinline__ void operator()(const f32x4 (&acc)[2][2][4][2], const pg8::Unit& u, int wr, int wc, int fr, int fq) const {
        const int row0 = u.pm * 256 + wr * 64 + fr;
        if (u.pn < 32) {
            const int ch0 = 64 * u.pn + 16 * wc + 4 * fq;
#pragma unroll
            for (int ai = 0; ai < 2; ++ai)
#pragma unroll
                for (int m = 0; m < 4; ++m) {
                    const f32x4 b = acc[ai][0][m][0], c = acc[ai][0][m][1], h = acc[ai][1][m][0], z = acc[ai][1][m][1];
                    u32x4 w;
                    w.x = pk2(c[0] * h[0], b[0] * silu_f(z[0])); w.y = pk2(c[1] * h[1], b[1] * silu_f(z[1]));
                    w.z = pk2(c[2] * h[2], b[2] * silu_f(z[2])); w.w = pk2(c[3] * h[3], b[3] * silu_f(z[3]));
                    *(u32x4*)(UG + ((size_t)(row0 + ai * 128 + m * 16) * CW + ch0) * 2) = w;
                }
        } else {
            const int col0 = 256 * (u.pn - 32) + 32 * wc + 8 * fq; const bool act = u.pn >= 44;
#pragma unroll
            for (int ai = 0; ai < 2; ++ai)
#pragma unroll
                for (int m = 0; m < 4; ++m) { bf16_t* rowp = QKVZ + (size_t)(row0 + ai * 128 + m * 16) * QW + col0;
#pragma unroll
                    for (int bj = 0; bj < 2; ++bj) { f32x4 v0 = acc[ai][bj][m][0], v1 = acc[ai][bj][m][1];
                        if (act) {
#pragma unroll
                            for (int j = 0; j < 4; ++j) { v0[j] = silu_f(v0[j]); v1[j] = silu_f(v1[j]); } }
                        u32x4 w; w.x = pk2(v0[0], v0[1]); w.y = pk2(v0[2], v0[3]); w.z = pk2(v1[0], v1[1]); w.w = pk2(v1[2], v1[3]);
                        *(u32x4*)(rowp + bj * 128) = w; } }
        }
    }
};
struct Epi2 {
    const float* x; const float* g1; const float* b1; const f32x2* stats; float* out;
    __device__ __forceinline__ void operator()(const f32x4 (&acc)[2][2][4][2], const pg8::Unit& u, int wr, int wc, int fr, int fq) const {
        const int row0 = u.pm * 256 + wr * 64 + fr, col0 = u.pn * 256 + wc * 32 + 4 * fq;
        f32x4 gv[2][2], bv[2][2];
#pragma unroll
        for (int bj = 0; bj < 2; ++bj)
#pragma unroll
            for (int n = 0; n < 2; ++n) { gv[bj][n] = *(const f32x4*)(g1 + col0 + bj * 128 + n * 16) * DN_ALPHA; bv[bj][n] = *(const f32x4*)(b1 + col0 + bj * 128 + n * 16) * DN_ALPHA; }
#pragma unroll
        for (int ai = 0; ai < 2; ++ai)
#pragma unroll
            for (int m = 0; m < 4; ++m) { const int row = row0 + ai * 128 + m * 16; const f32x2 st = stats[row]; const size_t off = (size_t)row * DM + col0;
#pragma unroll
                for (int bj = 0; bj < 2; ++bj)
#pragma unroll
                    for (int n = 0; n < 2; ++n) { const f32x4 xv = *(const f32x4*)(x + off + bj * 128 + n * 16);
                        const f32x4 hv = ((xv - st.x) * st.y) * gv[bj][n] + bv[bj][n];
                        *(f32x4*)(out + off + bj * 128 + n * 16) = acc[ai][bj][m][n] + hv; }
                asm volatile("" ::: "memory"); }
    }
};

__device__ __forceinline__ int win_row(int c) {
    int pn, bj, wc, fq, n, j;
    if (c < 8192) { const int part = c >> 11, ch = c & 2047; pn = ch >> 6; wc = (ch >> 4) & 3; fq = (ch >> 2) & 3; j = ch & 3; bj = part >> 1; n = part & 1; }
    else { const int cc = c - 8192, w = cc & 255; pn = 32 + (cc >> 8); bj = w >> 7; wc = (w >> 5) & 3; fq = (w >> 3) & 3; n = (w >> 2) & 1; j = w & 3; }
    return 256 * pn + 128 * bj + 32 * wc + 16 * n + 4 * fq + j;
}
template <bool PERMUTE>
__device__ __forceinline__ void p0_transpose_item(const float* W, int K, int N, bf16_t* WT, LAS float* scr, int item, int lane) {
    const int nblk = N / 32, kb = item / nblk, nb = item % nblk, k0 = 64 * kb, n0 = 32 * nb;
#pragma unroll 8
    for (int i = 0; i < 32; ++i) { const int kk = 2 * i + (lane >> 5); scr[kk * 33 + (lane & 31)] = W[(size_t)(k0 + kk) * N + n0 + (lane & 31)]; }
    asm volatile("s_waitcnt lgkmcnt(0)" ::: "memory");
    const int c = lane & 7;
#pragma unroll
    for (int j = 0; j < 4; ++j) { const int n = (lane >> 3) + 8 * j; const LAS float* s = scr + (8 * c) * 33 + n;
        u32x4 o; o.x = pk2(s[0 * 33], s[1 * 33]); o.y = pk2(s[2 * 33], s[3 * 33]); o.z = pk2(s[4 * 33], s[5 * 33]); o.w = pk2(s[6 * 33], s[7 * 33]);
        const int orow = PERMUTE ? win_row(n0 + n) : (n0 + n);
        *(u32x4*)(WT + (size_t)orow * K + k0 + 8 * c) = o; }
    asm volatile("s_waitcnt lgkmcnt(0)" ::: "memory");
}
__device__ __forceinline__ void phase0(const Params& p, LAS unsigned char* lds) {
    const int tid = threadIdx.x, lane = tid & 63, wave = __builtin_amdgcn_readfirstlane(tid >> 6);
    LAS float* scr = (LAS float*)(lds + wave * 16384);
    const int gw = blockIdx.x * 8 + wave, NGW = gridDim.x * 8;
    bf16_t* WinT = (bf16_t*)(p.ws + WS_WIN); bf16_t* WoutT = (bf16_t*)(p.ws + WS_WOUT); bf16_t* XN = (bf16_t*)(p.ws + WS_XN); f32x2* stats = (f32x2*)(p.ws + WS_STATS);
    for (int r = gw; r < SEQ; r += NGW) {
        const f32x4* xr = (const f32x4*)(p.x + (size_t)r * DM) + lane;
        f32x4 v[16]; float s = 0.f;
#pragma unroll
        for (int j = 0; j < 16; ++j) { v[j] = xr[64 * j]; s += (v[j].x + v[j].y) + (v[j].z + v[j].w); }
        const float mean = wave_sum(s) * (1.f / DM); float s2 = 0.f;
#pragma unroll
        for (int j = 0; j < 16; ++j) { v[j] = v[j] - mean; s2 += (v[j].x * v[j].x + v[j].y * v[j].y) + (v[j].z * v[j].z + v[j].w * v[j].w); }
        const float rstd = 1.f / sqrtf(wave_sum(s2) * (1.f / DM) + LN_EPS);
        u32x2* o8 = (u32x2*)(XN + (size_t)r * DM) + lane;
#pragma unroll
        for (int j = 0; j < 16; ++j) { const f32x4 gg = *((const f32x4*)p.g1 + 64 * j + lane), bb = *((const f32x4*)p.b1 + 64 * j + lane);
            const f32x4 h = v[j] * rstd * gg + bb; u32x2 w; w.x = pk2(h.x, h.y); w.y = pk2(h.z, h.w); o8[64 * j] = w; }
        if (lane == 0) stats[r] = (f32x2){mean, rstd};
    }
    constexpr int I_IN = (DM / 64) * (PW / 32), I_OUT = (DM / 64) * (DM / 32);
    for (int it = gw; it < I_IN + I_OUT; it += NGW) {
        if (it < I_IN) p0_transpose_item<true>(p.w_in, DM, PW, WinT, scr, it, lane);
        else p0_transpose_item<false>(p.w_out, DM, DM, WoutT, scr, it - I_IN, lane);
    }
}

__device__ __forceinline__ unsigned offb(unsigned row, unsigned ch) { return 256u * row + 16u * (ch ^ (((row & 3) << 2) | ((row >> 2) & 3))); }

__device__ __forceinline__ void conv_phase(const Params& p) {
    const unsigned* UG = (const unsigned*)(p.ws + WS_UG); bf16_t* Y = (bf16_t*)(p.ws + WS_Y);
    constexpr int R = 8;
    const int nitems = (SEQ / R) * (CW / 4);
    for (int it = blockIdx.x * 512 + threadIdx.x; it < nitems; it += gridDim.x * 512) {
        const int c4 = it & (CW / 4 - 1), t0 = (it / (CW / 4)) * R, c = 4 * c4;
        const f32x4 w0 = *(const f32x4*)(p.conv_w + c), w1 = *(const f32x4*)(p.conv_w + CW + c), w2 = *(const f32x4*)(p.conv_w + 2 * CW + c);
        u32x4 prev = (u32x4){0u, 0u, 0u, 0u}, cur, nxt;
        if (t0 > 0) prev = *(const u32x4*)(UG + (size_t)(t0 - 1) * CW + c);
        cur = *(const u32x4*)(UG + (size_t)t0 * CW + c);
#pragma unroll
        for (int r = 0; r < R; ++r) {
            const int t = t0 + r;
            nxt = (u32x4){0u, 0u, 0u, 0u};
            if (t + 1 < SEQ) nxt = *(const u32x4*)(UG + (size_t)(t + 1) * CW + c);
            float y[4];
#pragma unroll
            for (int j = 0; j < 4; ++j) y[j] = bf_hi(cur[j]) * (w0[j] * bf_lo(prev[j]) + w1[j] * bf_lo(cur[j]) + w2[j] * bf_lo(nxt[j]));
            u32x2 o; o.x = pk2(y[0], y[1]); o.y = pk2(y[2], y[3]);
            *(u32x2*)(Y + (size_t)t * DM + c) = o;
            prev = cur; cur = nxt;
        }
    }
}

__device__ __forceinline__ void attn_phase(const Params& p, LAS unsigned char* lds) {
    const int tid = threadIdx.x, lane = tid & 63, wid = __builtin_amdgcn_readfirstlane(tid >> 6);
    const int r = lane & 31, h = lane >> 5;
    const bf16_t* QKVZ = (const bf16_t*)(p.ws + WS_QKVZ); bf16_t* Y = (bf16_t*)(p.ws + WS_Y);
    const unsigned st_swz = (((unsigned)lane >> 4) << 2) | ((unsigned)wid & 3u);
    const unsigned st_voff = (unsigned)((4 * wid + (lane >> 4)) * QW * 2) + ((((unsigned)lane & 15u) ^ st_swz) * 16u);
    const unsigned swzr = (((unsigned)r & 3u) << 2) | (((unsigned)r >> 2) & 3u);
    const unsigned q4 = ((unsigned)lane >> 2) & 3u, p4 = (unsigned)lane & 3u, blk = ((unsigned)lane >> 4) & 1u;
    const unsigned kbase = 256u * (unsigned)r + 16u * ((unsigned)h ^ (swzr & 1u)), khi = swzr & 14u;
    const unsigned vlow = 2u * blk + (p4 >> 1);
    const unsigned vbase0 = 256u * (4u * (unsigned)h + q4) + 16u * (vlow ^ (unsigned)h) + 8u * (p4 & 1u);
    const unsigned vbase1 = 256u * (8u + 4u * (unsigned)h + q4) + 16u * (vlow ^ (2u + (unsigned)h)) + 8u * (p4 & 1u);
#define ATT_STAGE(kb, buf) do { const char* _g = (const char*)QKVZ + (size_t)(kb) * 128 * QW * 2 + (size_t)hk * 256; \
        _Pragma("unroll") for (int _i = 0; _i < 4; ++_i) { \
            __builtin_amdgcn_global_load_lds((const unsigned*)(_g + QOFF_K * 2 + (size_t)_i * 32 * QW * 2 + st_voff), (LAS unsigned*)(lds + (buf) * 65536 + (_i * 8 + wid) * 1024), 16, 0, 0); \
            __builtin_amdgcn_global_load_lds((const unsigned*)(_g + QOFF_V * 2 + (size_t)_i * 32 * QW * 2 + st_voff), (LAS unsigned*)(lds + (buf) * 65536 + 32768 + (_i * 8 + wid) * 1024), 16, 0, 0); } } while (0)
    for (int wi = blockIdx.x; wi < 256; wi += gridDim.x) {
        const int qb = wi >> 2, hk = wi & 3;
        for (int half = 0; half < 2; ++half) {
            const int g = half * 2 + (wid >> 2), hq = hk * 4 + g;
            const int tq = 128 * qb + 32 * (wid & 3) + r;
            const int kb_lo = qb > 0 ? qb - 1 : 0, kb_hi = qb < 63 ? qb + 1 : 63;
            ATT_STAGE(kb_lo, 0);
            bf16x8 qf[8];
#pragma unroll
            for (int s = 0; s < 8; ++s) qf[s] = *(const bf16x8*)(QKVZ + (size_t)tq * QW + hq * 128 + 16 * s + 8 * h);
            const float slope2 = __builtin_amdgcn_exp2f(-0.5f * (float)(hq + 1)) * LOG2E;
            const float c1 = 0.08838834764831845f * LOG2E;
            float mrun = p.sink[hq] * LOG2E, lrun = (h == 0) ? 1.f : 0.f;
            f32x16 O[4];
#pragma unroll
            for (int d = 0; d < 4; ++d)
#pragma unroll
                for (int e = 0; e < 16; ++e) O[d][e] = 0.f;
            asm volatile("s_waitcnt vmcnt(0)" ::: "memory"); __syncthreads();
            for (int kb = kb_lo; kb <= kb_hi; ++kb) {
                const int cur = (kb - kb_lo) & 1;
                if (kb < kb_hi) ATT_STAGE(kb + 1, cur ^ 1);
#pragma unroll 1
                for (int hf = 0; hf < 2; ++hf) {
                    const LAS unsigned char* Kb = lds + cur * 65536 + hf * 16384; const LAS unsigned char* Vb = Kb + 32768;
                    f32x16 S[2];
#pragma unroll
                    for (int kt = 0; kt < 2; ++kt) {
#pragma unroll
                        for (int e = 0; e < 16; ++e) S[kt][e] = 0.f;
#pragma unroll
                        for (int s = 0; s < 8; ++s) {
                            const bf16x8 kf = *(const LAS bf16x8*)(Kb + 8192 * kt + kbase + 16u * (((unsigned)(2 * s)) ^ khi));
                            S[kt] = __builtin_amdgcn_mfma_f32_32x32x16_bf16(kf, qf[s], S[kt], 0, 0, 0);
                        }
                    }
                    const float fbase = (float)(tq - 128 * kb - 64 * hf - 4 * h);
                    float mx = -3.0e38f;
#pragma unroll
                    for (int kt = 0; kt < 2; ++kt)
#pragma unroll
                        for (int e = 0; e < 16; ++e) {
                            const float d = __builtin_fabsf(fbase - (float)(32 * kt + 8 * (e >> 2) + (e & 3)));
                            float v = S[kt][e] * c1 - slope2 * d;
                            v = (d > 128.f) ? -1.0e30f : v;
                            S[kt][e] = v; mx = fmaxf(mx, v);
                        }
                    mx = fmaxf(mx, __shfl_xor(mx, 32));
                    const float mnew = fmaxf(mrun, mx), alpha = __builtin_amdgcn_exp2f(mrun - mnew);
                    mrun = mnew;
                    float ls = 0.f;
#pragma unroll
                    for (int kt = 0; kt < 2; ++kt)
#pragma unroll
                        for (int e = 0; e < 16; ++e) { const float pe = __builtin_amdgcn_exp2f(S[kt][e] - mnew); S[kt][e] = pe; ls += pe; }
                    lrun = lrun * alpha + ls;
#pragma unroll
                    for (int d = 0; d < 4; ++d)
#pragma unroll
                        for (int e = 0; e < 16; ++e) O[d][e] *= alpha;
#pragma unroll
                    for (int kt = 0; kt < 2; ++kt)
#pragma unroll
                        for (int s2 = 0; s2 < 2; ++s2) {
                            u32x4 pw; pw.x = pk2(S[kt][8 * s2 + 0], S[kt][8 * s2 + 1]); pw.y = pk2(S[kt][8 * s2 + 2], S[kt][8 * s2 + 3]);
                            pw.z = pk2(S[kt][8 * s2 + 4], S[kt][8 * s2 + 5]); pw.w = pk2(S[kt][8 * s2 + 6], S[kt][8 * s2 + 7]);
                            const bf16x8 pf = __builtin_bit_cast(bf16x8, pw);
#pragma unroll
                            for (int dt = 0; dt < 4; ++dt) {
                                const s16x4 v0 = __builtin_amdgcn_ds_read_tr16_b64_v4i16((LAS s16x4*)(Vb + 8192 * kt + 4096 * s2 + vbase0 + 64u * ((unsigned)dt ^ q4)));
                                const s16x4 v1 = __builtin_amdgcn_ds_read_tr16_b64_v4i16((LAS s16x4*)(Vb + 8192 * kt + 4096 * s2 + vbase1 + 64u * ((unsigned)dt ^ q4)));
                                bf16x8 vf; vf[0] = v0[0]; vf[1] = v0[1]; vf[2] = v0[2]; vf[3] = v0[3]; vf[4] = v1[0]; vf[5] = v1[1]; vf[6] = v1[2]; vf[7] = v1[3];
                                O[dt] = __builtin_amdgcn_mfma_f32_32x32x16_bf16(vf, pf, O[dt], 0, 0, 0);
                            }
                        }
                }
                asm volatile("s_waitcnt vmcnt(0)" ::: "memory"); __syncthreads();
            }
            const float ltot = lrun + __shfl_xor(lrun, 32), inv = 1.0f / ltot;
            const bf16_t* zrow = QKVZ + (size_t)tq * QW + QOFF_Z + hq * 128; bf16_t* yrow = Y + (size_t)tq * DM + CW + hq * 128;
#pragma unroll
            for (int dt = 0; dt < 4; ++dt)
#pragma unroll
                for (int rg = 0; rg < 4; ++rg) {
                    const int d0 = 32 * dt + 8 * rg + 4 * h;
                    const u32x2 zz = *(const u32x2*)(zrow + d0);
                    u32x2 o; o.x = pk2(O[dt][4 * rg + 0] * inv * bf_lo(zz.x), O[dt][4 * rg + 1] * inv * bf_hi(zz.x));
                    o.y = pk2(O[dt][4 * rg + 2] * inv * bf_lo(zz.y), O[dt][4 * rg + 3] * inv * bf_hi(zz.y));
                    *(u32x2*)(yrow + d0) = o;
                }
        }
    }
#undef ATT_STAGE
}

__device__ __forceinline__ void final_ln(const Params& p) {
    const int tid = threadIdx.x, lane = tid & 63, wave = tid >> 6;
    const int gw = blockIdx.x * 8 + wave, NGW = gridDim.x * 8;
    for (int r = gw; r < SEQ; r += NGW) {
        f32x4* xr = (f32x4*)(p.out + (size_t)r * DM) + lane;
        f32x4 v[16]; float s = 0.f;
#pragma unroll
        for (int j = 0; j < 16; ++j) { v[j] = xr[64 * j]; s += (v[j].x + v[j].y) + (v[j].z + v[j].w); }
        const float mean = wave_sum(s) * (1.f / DM); float s2 = 0.f;
#pragma unroll
        for (int j = 0; j < 16; ++j) { v[j] = v[j] - mean; s2 += (v[j].x * v[j].x + v[j].y * v[j].y) + (v[j].z * v[j].z + v[j].w * v[j].w); }
        const float rstd = 1.f / sqrtf(wave_sum(s2) * (1.f / DM) + LN_EPS);
#pragma unroll
        for (int j = 0; j < 16; ++j) { const f32x4 gg = *((const f32x4*)p.g2 + 64 * j + lane), bb = *((const f32x4*)p.b2 + 64 * j + lane);
            xr[64 * j] = v[j] * rstd * gg + bb; }
    }
}

__global__ void __launch_bounds__(512, 2) fwd_kernel(Params p) {
    extern __shared__ __attribute__((aligned(16))) unsigned char lds_raw[];
    LAS unsigned char* lds = (LAS unsigned char*)lds_raw;
    cg::grid_group grid = cg::this_grid();
    const int lo = p.ph_lo, hi = p.ph_hi;
#define IN(k) (lo <= (k) && (k) < hi)
#define SEAM(k) do { if (IN(k) && IN((k) + 1)) grid.sync(); } while (0)
    if (IN(0)) phase0(p, lds);
    SEAM(0);
    if (IN(1)) {
        pg8::Gemm g{(const bf16_t*)(p.ws + WS_XN), (const bf16_t*)(p.ws + WS_WIN), SEQ, PW, DM};
        pg8::StaticOrder S; S.init(SEQ, PW, (int)gridDim.x, (int)blockIdx.x);
        Epi1 E{(bf16_t*)(p.ws + WS_UG), (bf16_t*)(p.ws + WS_QKVZ)};
        pg8::gemm_phase<Epi1>(lds, g, S, E);
    }
    SEAM(1);
    if (IN(2)) { conv_phase(p); attn_phase(p, lds); }
    SEAM(2);
    if (IN(3)) {
        pg8::Gemm g{(const bf16_t*)(p.ws + WS_Y), (const bf16_t*)(p.ws + WS_WOUT), SEQ, DM, DM};
        pg8::StaticOrder S; S.init(SEQ, DM, (int)gridDim.x, (int)blockIdx.x);
        Epi2 E{p.x, p.g1, p.b1, (const f32x2*)(p.ws + WS_STATS), p.out};
        pg8::gemm_phase<Epi2>(lds, g, S, E);
    }
    SEAM(3);
    if (IN(4)) final_ln(p);
#undef IN
#undef SEAM
}

extern "C" void kernel_launch(void* const* d_in, const int* in_sizes, int n_in, void* d_out, int out_size, void* d_ws, size_t ws_size, hipStream_t stream) {
    static int grid = 0;
    if (grid == 0) {
        if (n_in != 9 || out_size != SEQ * DM || ws_size < WS_END) { fprintf(stderr, "kernel_launch: unexpected shapes (n_in %d out %d ws %zu)\n", n_in, out_size, ws_size); grid = -1; return; }
        int dev = 0, cus = 0, per_cu = 0;
        hipGetDevice(&dev);
        hipDeviceGetAttribute(&cus, hipDeviceAttributeMultiprocessorCount, dev);
        if (hipFuncSetAttribute((const void*)fwd_kernel, hipFuncAttributeMaxDynamicSharedMemorySize, LDS_BYTES) != hipSuccess) { fprintf(stderr, "kernel_launch: hipFuncSetAttribute failed\n"); grid = -1; return; }
        if (hipOccupancyMaxActiveBlocksPerMultiprocessor(&per_cu, (const void*)fwd_kernel, 512, LDS_BYTES) != hipSuccess || per_cu < 1) { fprintf(stderr, "kernel_launch: occupancy query says %d\n", per_cu); per_cu = 1; }
        (void)hipGetLastError();
        grid = cus * per_cu;
    }
    if (grid < 0) return;
    Params p{};
    p.x = (const float*)d_in[0]; p.g1 = (const float*)d_in[1]; p.b1 = (const float*)d_in[2]; p.w_in = (const float*)d_in[3]; p.conv_w = (const float*)d_in[4];
    p.sink = (const float*)d_in[5]; p.w_out = (const float*)d_in[6]; p.g2 = (const float*)d_in[7]; p.b2 = (const float*)d_in[8];
    p.out = (float*)d_out; p.ws = (unsigned char*)d_ws;
#if N_LAUNCHES == 1
    p.ph_lo = 0; p.ph_hi = 5;
    void* args[] = {&p};
    hipError_t e = hipLaunchCooperativeKernel((const void*)fwd_kernel, dim3(grid), dim3(512), args, LDS_BYTES, stream);
    if (e != hipSuccess) fprintf(stderr, "cooperative launch failed: %s (grid %d)\n", hipGetErrorString(e), grid);
#else
    for (int k = 0; k < 5; ++k) {
        p.ph_lo = k; p.ph_hi = k + 1;
        hipLaunchKernelGGL(fwd_kernel, dim3(grid), dim3(512), LDS_BYTES, stream, p);
    }
#endif
}
```
